# Optimizing an MI355X kernel written in HIP

```python
import math
import jax
import jax.numpy as jnp
from jax import lax
import numpy as np

D_MODEL = 1024
BATCH = 1
SEQ = 16384
DEPTH = 1
DEC_BATCH = 32
DEC_SEQ = 1
PAST_LEN = 16384
PAGE_SIZE = 128

W_ATT = D_MODEL // 2
HD_ATT = 64
H_ATT = W_ATT // HD_ATT
DILATIONS = ((128, 1), (512, 4), (2048, 16))
MAX_WINDOW = max(w for w, _ in DILATIONS)
Q_BLOCK = 128
N_BUCKETS = 32
MAX_EXACT = N_BUCKETS // 2
BUCKET_MAX_DIST = MAX_WINDOW
W_RET = D_MODEL - W_ATT
H_RET = 4
DK_RET = W_RET // H_RET
DV_RET = W_RET // H_RET
RET_CHUNK = 128
ROPE_BASE = 10000.0
W_MIX = W_ATT + W_RET
D_FF = 4 * D_MODEL
SPLITS = (W_ATT, W_ATT, W_ATT, H_RET * DK_RET, H_RET * DK_RET, H_RET * DV_RET, H_RET * DV_RET)
D_IN = sum(SPLITS)
ALPHA = (2.0 * DEPTH) ** 0.25
BETA = (8.0 * DEPTH) ** -0.25
LN_EPS = 1e-5
GN_EPS = 1e-6

kernel_name = 'hybrid_dilated_attn_retention_decoder_step'

F32 = jnp.float32


def layernorm(x, g, b):
    xf = x.astype(F32)
    mu = xf.mean(-1, keepdims=True)
    var = jnp.square(xf - mu).mean(-1, keepdims=True)
    return ((xf - mu) * lax.rsqrt(var + LN_EPS) * g.astype(F32) + b.astype(F32)).astype(x.dtype)


def t5_bucket(dist):
    is_small = dist < MAX_EXACT
    d_f = jnp.maximum(dist, 1).astype(F32)
    large = MAX_EXACT + (jnp.log(d_f / MAX_EXACT) / math.log(BUCKET_MAX_DIST / MAX_EXACT)
                         * (N_BUCKETS - MAX_EXACT)).astype(jnp.int32)
    large = jnp.minimum(large, N_BUCKETS - 1)
    return jnp.where(is_small, dist, large)


def softmax_stats(logits):
    m = logits.max(-1, keepdims=True)
    p = jnp.exp(logits - m)
    s = p.sum(-1, keepdims=True)
    return p / s, (m + jnp.log(s))[..., 0]


def in_projection(x, w_in):
    B, T, _ = x.shape
    u = jnp.einsum('btd,de->bte', x, w_in)
    offs = np.cumsum(SPLITS)[:-1].tolist()
    q_a, k_a, v_a, q_r, k_r, v_r, g_r = jnp.split(u, offs, axis=-1)
    return (q_a.reshape(B, T, H_ATT, HD_ATT), k_a.reshape(B, T, H_ATT, HD_ATT),
            v_a.reshape(B, T, H_ATT, HD_ATT), q_r.reshape(B, T, H_RET, DK_RET),
            k_r.reshape(B, T, H_RET, DK_RET), v_r.reshape(B, T, H_RET, DV_RET), g_r)


def dilated_branch_prompt(q, k, v, window, dil, rel_bias):
    B, S, H, Dh = q.shape
    sub_win = window // dil
    L = S // dil
    Lp = -(-L // Q_BLOCK) * Q_BLOCK
    nb = Lp // Q_BLOCK
    N = B * dil

    def to_sub(t):
        t = t.astype(F32).reshape(B, L, dil, H, Dh).transpose(0, 2, 1, 3, 4).reshape(N, L, H, Dh)
        return jnp.pad(t, ((0, 0), (0, Lp - L), (0, 0), (0, 0)))

    def band(t):
        prev = jnp.pad(t, ((0, 0), (Q_BLOCK, 0), (0, 0), (0, 0)))[:, :Lp]
        return jnp.concatenate([prev.reshape(N, nb, Q_BLOCK, H, Dh),
                                t.reshape(N, nb, Q_BLOCK, H, Dh)], axis=2)

    qs, ks, vs = to_sub(q), to_sub(k), to_sub(v)
    qb = qs.reshape(N, nb, Q_BLOCK, H, Dh)
    kb, vb = band(ks), band(vs)
    rel = jnp.arange(Q_BLOCK)[:, None] + Q_BLOCK - jnp.arange(2 * Q_BLOCK)[None, :]
    key_idx = (jnp.arange(nb)[:, None, None] * Q_BLOCK
               + jnp.arange(2 * Q_BLOCK)[None, None, :] - Q_BLOCK)
    valid = (rel >= 0) & (rel <= sub_win) & (key_idx >= 0)
    bias = rel_bias[t5_bucket(jnp.clip(rel, 0, sub_win) * dil)].astype(F32).transpose(2, 0, 1)
    logits = jnp.einsum('nbqhd,nbkhd->nbhqk', qb, kb) * HD_ATT ** -0.5 + bias[None, None]
    logits = jnp.where(valid[None, :, None], logits, -jnp.inf)
    p, lse = softmax_stats(logits)
    o = jnp.einsum('nbhqk,nbkhd->nbqhd', p, vb)
    o = o.reshape(N, Lp, H, Dh)[:, :L].reshape(B, dil, L, H, Dh).transpose(0, 2, 1, 3, 4)
    lse = lse.transpose(0, 1, 3, 2).reshape(N, Lp, H)[:, :L].reshape(B, dil, L, H).transpose(0, 2, 1, 3)
    return o.reshape(B, S, H, Dh), lse.reshape(B, S, H)


def dilated_branch_sample(q, k_all, v_all, window, dil, rel_bias):
    B, T, H, Dh = q.shape
    W = k_all.shape[1] - T
    taps = jnp.arange(window // dil + 1)
    idx = W + jnp.arange(T)[:, None] - taps[None, :] * dil
    valid = idx >= 0
    idx = jnp.maximum(idx, 0)
    kg = k_all.astype(F32)[:, idx]
    vg = v_all.astype(F32)[:, idx]
    bias = rel_bias[t5_bucket(taps * dil)].astype(F32).T
    logits = jnp.einsum('bthd,btjhd->bthj', q.astype(F32), kg) * HD_ATT ** -0.5 + bias[None, None]
    logits = jnp.where(valid[None, :, None, :], logits, -jnp.inf)
    p, lse = softmax_stats(logits)
    o = jnp.einsum('bthj,btjhd->bthd', p, vg)
    return o, lse


def mix_dilations(branches):
    lse = jnp.stack([b[1] for b in branches], axis=-1)
    w = jax.nn.softmax(lse, axis=-1)
    return sum(w[..., i, None] * o for i, (o, _) in enumerate(branches))


def rotary(x, pos):
    half = x.shape[-1] // 2
    inv_freq = 1.0 / (ROPE_BASE ** jnp.linspace(0.0, 1.0, half, dtype=F32))
    ang = pos.astype(F32)[:, None] * inv_freq[None, :]
    cos, sin = jnp.cos(ang)[None, :, None, :], jnp.sin(ang)[None, :, None, :]
    x1, x2 = x[..., :half].astype(F32), x[..., half:].astype(F32)
    return jnp.concatenate([x1 * cos - x2 * sin, x1 * sin + x2 * cos], axis=-1)


def log_gamma():
    return jnp.log(1.0 - jnp.exp2(-5.0 - jnp.arange(H_RET, dtype=F32)))


def retention_chunk(q, k, v, state):
    C = q.shape[1]
    lg = log_gamma()
    n = jnp.arange(C, dtype=F32)
    diff = n[:, None] - n[None, :]
    decay = jnp.where(diff >= 0, jnp.exp(lg[:, None, None] * jnp.maximum(diff, 0.0)), 0.0)
    scores = jnp.einsum('bqhd,bkhd->bhqk', q, k) * decay
    o_inner = jnp.einsum('bhqk,bkhv->bqhv', scores, v)
    o_cross = jnp.einsum('bqhd,bhdv->bqhv', q, state) * jnp.exp(lg[None, :] * (n[:, None] + 1.0))[None, :, :, None]
    k_dec = k * jnp.exp(lg[None, :] * (C - 1.0 - n[:, None]))[None, :, :, None]
    new_state = jnp.exp(lg * C)[None, :, None, None] * state + jnp.einsum('bkhd,bkhv->bhdv', k_dec, v)
    return o_inner + o_cross, new_state


def retention_prompt(q, k, v):
    B, S, H, Dk = q.shape
    nc = S // RET_CHUNK

    def chunks(t):
        return t.reshape(B, nc, RET_CHUNK, H, t.shape[-1]).transpose(1, 0, 2, 3, 4)

    def step(state, xs):
        qc, kc, vc = xs
        o, state = retention_chunk(qc, kc, vc, state)
        return state, o

    s0 = jnp.zeros((B, H, DK_RET, DV_RET), F32)
    s_fin, o = lax.scan(step, s0, (chunks(q), chunks(k), chunks(v)))
    return o.transpose(1, 0, 2, 3, 4).reshape(B, S, H, DV_RET), s_fin


def retention_output(o, g):
    B, T = o.shape[:2]
    mu = o.mean(-1, keepdims=True)
    var = jnp.square(o - mu).mean(-1, keepdims=True)
    y = ((o - mu) * lax.rsqrt(var + GN_EPS)).reshape(B, T, W_RET)
    return jax.nn.silu(g.astype(F32)) * y


def layer_output(x, o_att, y_ret, w_out, ln1_g, ln1_b, w_up, w_down, ln2_g, ln2_b):
    B, T, _ = x.shape
    heads = jnp.concatenate([o_att.reshape(B, T, W_ATT), y_ret], axis=-1).astype(x.dtype)
    mix = jnp.einsum('bte,ed->btd', heads, w_out)
    x1 = layernorm(ALPHA * x + mix, ln1_g, ln1_b)
    h = jnp.square(jax.nn.relu(jnp.einsum('btd,df->btf', x1, w_up)))
    ffn = jnp.einsum('btf,fd->btd', h, w_down)
    return layernorm(ALPHA * x1 + ffn, ln2_g, ln2_b)


def setup_inputs(seed: int = 0) -> dict:
    key = jax.random.key(seed)
    ks = jax.random.split(key, 16)
    nrm = jax.random.normal
    win_buf = min(MAX_WINDOW, PAST_LEN)
    col_scale = np.ones((D_IN,), np.float32)
    offs = np.cumsum((0,) + SPLITS)
    col_scale[offs[2]:offs[3]] = BETA
    col_scale[offs[5]:offs[6]] = BETA
    return {
        'x_prompt': nrm(ks[0], (BATCH, SEQ, D_MODEL), F32),
        'x_sample': nrm(ks[1], (DEC_BATCH, DEC_SEQ, D_MODEL), F32),
        'cache_kv_win': nrm(ks[2], (DEPTH, DEC_BATCH, win_buf, 2, H_ATT, HD_ATT), F32),
        'state_ret': 0.5 * nrm(ks[3], (DEPTH, DEC_BATCH, H_RET, DK_RET, DV_RET), F32),
        'w_in': nrm(ks[4], (DEPTH, D_MODEL, D_IN), F32) * D_MODEL ** -0.5 * jnp.asarray(col_scale),
        'rel_bias': 0.5 * nrm(ks[5], (N_BUCKETS, H_ATT), F32),
        'w_out': nrm(ks[6], (DEPTH, W_MIX, D_MODEL), F32) * W_MIX ** -0.5 * BETA,
        'ln1_g': 1.0 + 0.05 * nrm(ks[7], (DEPTH, D_MODEL), F32),
        'ln1_b': 0.02 * nrm(ks[8], (DEPTH, D_MODEL), F32),
        'w_up': nrm(ks[9], (DEPTH, D_MODEL, D_FF), F32) * D_MODEL ** -0.5,
        'w_down': nrm(ks[10], (DEPTH, D_FF, D_MODEL), F32) * D_FF ** -0.5 * BETA,
        'ln2_g': 1.0 + 0.05 * nrm(ks[11], (DEPTH, D_MODEL), F32),
        'ln2_b': 0.02 * nrm(ks[12], (DEPTH, D_MODEL), F32),
    }


def reference(x_prompt, x_sample, cache_kv_win, state_ret, w_in, rel_bias, w_out,
              ln1_g, ln1_b, w_up, w_down, ln2_g, ln2_b):
    pos_p = jnp.arange(x_prompt.shape[1], dtype=jnp.int32)
    pos_s = PAST_LEN + jnp.arange(x_sample.shape[1], dtype=jnp.int32)
    hp, hs = x_prompt, x_sample
    kv_p_list, kv_s_list, st_p_list, st_s_list = [], [], [], []
    for l in range(DEPTH):
        q_a, k_a, v_a, q_r, k_r, v_r, g_r = in_projection(hp, w_in[l])
        o_att = mix_dilations([dilated_branch_prompt(q_a, k_a, v_a, w, d, rel_bias) for w, d in DILATIONS])
        o_ret, st_p = retention_prompt(rotary(q_r, pos_p), rotary(k_r, pos_p) * DK_RET ** -0.5,
                                       v_r.astype(F32))
        y_ret = retention_output(o_ret, g_r)
        win_p = min(MAX_WINDOW, hp.shape[1])
        kv_p_list.append(jnp.stack([k_a, v_a], axis=2)[:, -win_p:])
        st_p_list.append(st_p)
        hp_next = layer_output(hp, o_att, y_ret, w_out[l], ln1_g[l], ln1_b[l], w_up[l], w_down[l],
                               ln2_g[l], ln2_b[l])

        q_a, k_a, v_a, q_r, k_r, v_r, g_r = in_projection(hs, w_in[l])
        kv_buf = cache_kv_win[l]
        k_all = jnp.concatenate([kv_buf[:, :, 0].astype(k_a.dtype), k_a], axis=1)
        v_all = jnp.concatenate([kv_buf[:, :, 1].astype(v_a.dtype), v_a], axis=1)
        o_att = mix_dilations([dilated_branch_sample(q_a, k_all, v_all, w, d, rel_bias) for w, d in DILATIONS])
        o_ret, st_s = retention_chunk(rotary(q_r, pos_s), rotary(k_r, pos_s) * DK_RET ** -0.5,
                                      v_r.astype(F32), state_ret[l].astype(F32))
        y_ret = retention_output(o_ret, g_r)
        kv_s_list.append(jnp.stack([k_a, v_a], axis=2))
        st_s_list.append(st_s)
        hs_next = layer_output(hs, o_att, y_ret, w_out[l], ln1_g[l], ln1_b[l], w_up[l], w_down[l],
                               ln2_g[l], ln2_b[l])
        hp, hs = hp_next, hs_next
    kv_win_prompt = jnp.stack(kv_p_list)
    kv_win_sample = jnp.stack(kv_s_list)
    state_ret_prompt = jnp.stack(st_p_list)
    state_ret_sample = jnp.stack(st_s_list)
    return (hp, hs, kv_win_prompt, kv_win_sample, state_ret_prompt, state_ret_sample)
```

```cpp
#include <hip/hip_runtime.h>
#include <hip/hip_cooperative_groups.h>
#include <cstdio>
#include <cstdint>
#include <cmath>
namespace cg = cooperative_groups;
namespace pg8 {
#define PG8_LAS __attribute__((address_space(3)))
typedef unsigned short bf16_t;
typedef short bf16x8 __attribute__((ext_vector_type(8)));
typedef float f32x4 __attribute__((ext_vector_type(4)));
typedef unsigned u32x4 __attribute__((ext_vector_type(4)));
constexpr int BM = 256, BK = 64, HALF = 128, HTB = HALF * BK * 2  , STAGE_BYTES = 8 * HTB, NXCD = 8, WGM = 8;

__host__ __device__ __forceinline__ int lds_byte(int r, int c) { const int st = (r >> 4) * 2 + (c >> 5), rr = r & 15, cc = c & 31, ob = rr * 64 + cc * 2; return st * 1024 + (ob ^ (((ob >> 9) & 1) << 5)); }
__host__ __device__ __forceinline__ void stage_rc(int b, int& R, int& C) { const int st = b / 1024, sb = b % 1024, swz = sb ^ (((sb >> 9) & 1) << 5); R = (st >> 1) * 16 + swz / 64; C = (st & 1) * 32 + (swz % 64) / 2; }
__host__ __device__ __forceinline__ int perm32(int rho) { const int n = rho >> 4, i = rho & 15; return 8 * (i >> 2) + 4 * n + (i & 3); }

struct Unit { int pm, pn; };
struct Gemm { const bf16_t* A; const bf16_t* Bt; int M, N, K; };

struct StaticOrder {
    int nM, nN, nwg, G, c;
    __host__ __device__ void init(int M, int N, int G_, int c_) { nM = M / BM; nN = N / BM; nwg = nM * nN; G = G_; c = c_; }
    __host__ __device__ bool next(int i, Unit& u) const {
        const long L = (long)i * G + c; if (L >= nwg) return false;
        int wgid = (int)L; { const int q = nwg / NXCD, r = nwg % NXCD, xcd = wgid % NXCD, off = wgid / NXCD; wgid = (xcd < r ? xcd * (q + 1) : r * (q + 1) + (xcd - r) * q) + off; }
        const int nig = WGM * nN, gid = wgid / nig, fm = gid * WGM, gsz = (nM - fm) < WGM ? (nM - fm) : WGM;
        u.pm = fm + ((wgid % nig) % gsz); u.pn = (wgid % nig) / gsz; return true;
    }
    __device__ __forceinline__ void a_ready(const Unit&) const {}
    __device__ __forceinline__ void done(const Unit&) const {}
};

__device__ __forceinline__ unsigned cvt_pk_bf16(float lo, float hi) { unsigned r; asm volatile("v_cvt_pk_bf16_f32 %0, %1, %2" : "=v"(r) : "v"(lo), "v"(hi)); return r; }
typedef unsigned u32x2 __attribute__((ext_vector_type(2)));
struct EpiU {
    static constexpr bool PERM = true, AFTER_DRAIN = false;
    bf16_t* U; int ldc; float* kvp; float* kvs;
    __device__ __forceinline__ void operator()(const f32x4 (&acc)[2][2][4][2], const Unit& u, int wr, int wc, int fr, int fq) const {
        const int rt0 = wr * 64 + fr, col0 = u.pn * BM + wc * 32 + 8 * fq;
        const bool kv = (u.pn >= 2) && (u.pn <= 5) && (u.pm >= 56);
        const int kvsel = (u.pn - 2) >> 1, c512 = ((u.pn - 2) & 1) * 256 + wc * 32 + 8 * fq;
#pragma unroll
        for (int ai = 0; ai < 2; ++ai)
#pragma unroll
            for (int m = 0; m < 4; ++m) { const int rt = rt0 + ai * HALF + m * 16; bf16_t* rowp = U + (size_t)(u.pm * BM + rt) * ldc + col0;
#pragma unroll
                for (int bj = 0; bj < 2; ++bj) { const f32x4 v0 = acc[ai][bj][m][0], v1 = acc[ai][bj][m][1];
                    u32x4 w; w.x = cvt_pk_bf16(v0[0], v0[1]); w.y = cvt_pk_bf16(v0[2], v0[3]); w.z = cvt_pk_bf16(v1[0], v1[1]); w.w = cvt_pk_bf16(v1[2], v1[3]);
                    *(u32x4*)(rowp + bj * HALF) = w;
                    if (kv) {
                        float* dst = nullptr;
                        if (u.pm < 64) dst = kvp + (size_t)((u.pm - 56) * BM + rt) * 1024 + kvsel * 512 + c512 + bj * HALF;
                        else if (rt < 32) dst = kvs + (size_t)rt * 1024 + kvsel * 512 + c512 + bj * HALF;
                        if (dst) { *(f32x4*)dst = v0; *(f32x4*)(dst + 4) = v1; }
                    } } }
    }
};
struct EpiRelu2 {
    static constexpr bool PERM = true, AFTER_DRAIN = false;
    bf16_t* O; int ldc;
    __device__ __forceinline__ void operator()(const f32x4 (&acc)[2][2][4][2], const Unit& u, int wr, int wc, int fr, int fq) const {
        const int row0 = u.pm * BM + wr * 64 + fr, col0 = u.pn * BM + wc * 32 + 8 * fq;
#pragma unroll
        for (int ai = 0; ai < 2; ++ai)
#pragma unroll
            for (int m = 0; m < 4; ++m) { bf16_t* rowp = O + (size_t)(row0 + ai * HALF + m * 16) * ldc + col0;
#pragma unroll
                for (int bj = 0; bj < 2; ++bj) { f32x4 v0 = acc[ai][bj][m][0], v1 = acc[ai][bj][m][1];
#pragma unroll
                    for (int e = 0; e < 4; ++e) { const float a = fmaxf(v0[e], 0.f), b = fmaxf(v1[e], 0.f); v0[e] = a * a; v1[e] = b * b; }
                    u32x4 w; w.x = cvt_pk_bf16(v0[0], v0[1]); w.y = cvt_pk_bf16(v0[2], v0[3]); w.z = cvt_pk_bf16(v1[0], v1[1]); w.w = cvt_pk_bf16(v1[2], v1[3]);
                    *(u32x4*)(rowp + bj * HALF) = w; } }
    }
};
struct EpiF32 {
    static constexpr bool PERM = false, AFTER_DRAIN = false;
    float* C; int ldc;
    __device__ __forceinline__ void operator()(const f32x4 (&acc)[2][2][4][2], const Unit& u, int wr, int wc, int fr, int fq) const {
        const int row0 = u.pm * BM + wr * 64 + fr, col0 = u.pn * BM + wc * 32 + 4 * fq;
#pragma unroll
        for (int ai = 0; ai < 2; ++ai)
#pragma unroll
            for (int m = 0; m < 4; ++m) { float* rowp = C + (size_t)(row0 + ai * HALF + m * 16) * ldc + col0;
#pragma unroll
                for (int bj = 0; bj < 2; ++bj)
#pragma unroll
                    for (int n = 0; n < 2; ++n) *(f32x4*)(rowp + bj * HALF + n * 16) = acc[ai][bj][m][n]; }
    }
};
template <class Epi, class Sched, bool ALIGN_EPI = false, bool SP2 = false>
__device__ __forceinline__ void gemm_phase(PG8_LAS unsigned char* lds, const Gemm g, const Sched& S, const Epi& E) {
    const int tid = threadIdx.x, wid = __builtin_amdgcn_readfirstlane(tid >> 6), lane = tid & 63, wr = wid >> 2, wc = wid & 3, fr = lane & 15, fq = lane >> 4;
    const int K = g.K, nt = K / BK;
    unsigned voffA[2], voffB[2];
#pragma unroll
    for (int i = 0; i < 2; ++i) { int R, C; stage_rc(tid * 16 + i * 8192, R, C); const int Rb = Epi::PERM ? ((R & ~31) + perm32(R & 31)) : R;
        voffA[i] = (unsigned)(R * K + C) * 2u; voffB[i] = (unsigned)(Rb * K + C) * 2u; }
    const size_t kstep = (size_t)(BK * 2);
    const size_t hstep = (size_t)HALF * K * 2;
    const size_t tstep = 2 * hstep;
    const unsigned ldsw = (unsigned)wid * 1024u;
    const int aoff = lds_byte(wr * 64 + fr, fq * 8), boff = lds_byte(wc * 32 + fr, fq * 8);
#define PG8_SA(b, h) (((b) * 2 + (h)) * HTB)
#define PG8_SB(b, h) ((4 + (b) * 2 + (h)) * HTB)
#define PG8_STAGE(bufoff, gbase, voff) do { _Pragma("unroll") for (int _i = 0; _i < 2; ++_i) \
        __builtin_amdgcn_global_load_lds((const unsigned*)((const char*)(gbase) + (voff)[_i]), (PG8_LAS unsigned*)(lds + (bufoff) + ldsw + _i * 8192), 16, 0, 0); } while (0)
#define PG8_LDA(dst, b, h) do { _Pragma("unroll") for (int m = 0; m < 4; ++m) _Pragma("unroll") for (int k = 0; k < 2; ++k) dst[m][k] = *(const PG8_LAS bf16x8*)(lds + PG8_SA(b, h) + aoff + m * 2048 + k * 1024); } while (0)
#define PG8_LDB(dst, b, h) do { _Pragma("unroll") for (int n = 0; n < 2; ++n) _Pragma("unroll") for (int k = 0; k < 2; ++k) dst[n][k] = *(const PG8_LAS bf16x8*)(lds + PG8_SB(b, h) + boff + n * 2048 + k * 1024); } while (0)
#define PG8_MMA(ai, bj, At, Bt) do { __builtin_amdgcn_s_setprio(1); _Pragma("unroll") for (int m = 0; m < 4; ++m) _Pragma("unroll") for (int n = 0; n < 2; ++n) _Pragma("unroll") for (int k = 0; k < 2; ++k) \
        acc[ai][bj][m][n] = __builtin_amdgcn_mfma_f32_16x16x32_bf16(Bt[n][k], At[m][k], acc[ai][bj][m][n], 0, 0, 0); __builtin_amdgcn_s_setprio(0); } while (0)
#define PG8_WAIT_V(n) asm volatile("s_waitcnt vmcnt(" #n ")" ::: "memory")
#define PG8_WAIT_L(n) asm volatile("s_waitcnt lgkmcnt(" #n ")" ::: "memory")
#define PG8_BAR __builtin_amdgcn_s_barrier()
#define PG8_SCHED __builtin_amdgcn_sched_barrier(0)
    Unit cur, nxt; int ui = 0;
    if (!S.next(0, cur)) return;
    f32x4 acc[2][2][4][2];
#pragma unroll
    for (int a = 0; a < 2; ++a)
#pragma unroll
        for (int b = 0; b < 2; ++b)
#pragma unroll
            for (int m = 0; m < 4; ++m)
#pragma unroll
                for (int n = 0; n < 2; ++n) acc[a][b][m][n] = (f32x4){0.f, 0.f, 0.f, 0.f};
    bf16x8 At[4][2], B0[2][2], B1[2][2];
    const char* cA = (const char*)g.A + (size_t)cur.pm * tstep; const char* cB = (const char*)g.Bt + (size_t)cur.pn * tstep;
    S.a_ready(cur);
    if constexpr (SP2) {
        PG8_STAGE(PG8_SB(0, 0), cB, voffB); PG8_STAGE(PG8_SB(0, 1), cB + hstep, voffB); PG8_STAGE(PG8_SA(0, 0), cA, voffA); PG8_STAGE(PG8_SA(0, 1), cA + hstep, voffA);
        if (wr == 1) PG8_BAR;
        PG8_WAIT_V(2); PG8_BAR;
        PG8_STAGE(PG8_SB(1, 0), cB + kstep, voffB); PG8_STAGE(PG8_SA(1, 0), cA + kstep, voffA); PG8_STAGE(PG8_SB(1, 1), cB + hstep + kstep, voffB);
        PG8_WAIT_V(6); PG8_BAR;
    } else {
        PG8_STAGE(PG8_SB(0, 0), cB, voffB); PG8_STAGE(PG8_SA(0, 0), cA, voffA); PG8_STAGE(PG8_SB(0, 1), cB + hstep, voffB); PG8_STAGE(PG8_SA(0, 1), cA + hstep, voffA);
        if (wr == 1) PG8_BAR;
        PG8_WAIT_V(4); PG8_BAR;
        PG8_STAGE(PG8_SB(1, 0), cB + kstep, voffB); PG8_STAGE(PG8_SA(1, 0), cA + kstep, voffA); PG8_STAGE(PG8_SB(1, 1), cB + hstep + kstep, voffB);
        PG8_WAIT_V(6); PG8_BAR;
    }
    for (;;) {
        const bool has_next = S.next(ui + 1, nxt);
        const char* nA = has_next ? (const char*)g.A + (size_t)nxt.pm * tstep : cA; const char* nB = has_next ? (const char*)g.Bt + (size_t)nxt.pn * tstep : cB;
        for (int t = 0; t < nt; t += 2) {
            const bool last = (t == nt - 2);
            const char* a1 = cA + (size_t)(t + 1) * kstep;
            const char* a2 = last ? nA : cA + (size_t)(t + 2) * kstep; const char* b2 = last ? nB : cB + (size_t)(t + 2) * kstep;
            const char* a3 = a2 + kstep; const char* b3 = b2 + kstep;
            if (last && has_next) S.a_ready(nxt);
            if constexpr (SP2) {
            PG8_LDB(B0, 0, 0); PG8_LDB(B1, 0, 1); PG8_SCHED; PG8_LDA(At, 0, 0); PG8_STAGE(PG8_SA(1, 1), a1 + hstep, voffA);
            PG8_WAIT_V(8); PG8_WAIT_L(0); PG8_BAR; PG8_MMA(0, 0, At, B0); PG8_MMA(0, 1, At, B1); PG8_BAR; PG8_SCHED;
            PG8_LDA(At, 0, 1); PG8_STAGE(PG8_SB(0, 0), b2, voffB); PG8_STAGE(PG8_SB(0, 1), b2 + hstep, voffB); PG8_STAGE(PG8_SA(0, 0), a2, voffA);
            PG8_WAIT_V(8); PG8_WAIT_L(0); PG8_BAR; PG8_MMA(1, 0, At, B0); PG8_MMA(1, 1, At, B1); PG8_BAR; PG8_SCHED;
            PG8_LDB(B0, 1, 0); PG8_LDB(B1, 1, 1); PG8_SCHED; PG8_LDA(At, 1, 0); PG8_STAGE(PG8_SA(0, 1), a2 + hstep, voffA);
            PG8_WAIT_V(8); PG8_WAIT_L(0); PG8_BAR; PG8_MMA(0, 0, At, B0); PG8_MMA(0, 1, At, B1); PG8_BAR; PG8_SCHED;
            PG8_LDA(At, 1, 1); PG8_STAGE(PG8_SB(1, 0), b3, voffB); PG8_STAGE(PG8_SB(1, 1), b3 + hstep, voffB); PG8_STAGE(PG8_SA(1, 0), a3, voffA);
            PG8_WAIT_V(8); PG8_WAIT_L(0); PG8_BAR; PG8_MMA(1, 0, At, B0); PG8_MMA(1, 1, At, B1); PG8_BAR; PG8_SCHED;
            } else {
            PG8_LDB(B0, 0, 0); PG8_SCHED; PG8_LDA(At, 0, 0); PG8_STAGE(PG8_SA(1, 1), a1 + hstep, voffA);
            PG8_WAIT_L(8); PG8_BAR; PG8_WAIT_L(0); PG8_MMA(0, 0, At, B0); PG8_BAR; PG8_SCHED;
            PG8_LDB(B1, 0, 1); PG8_STAGE(PG8_SB(0, 0), b2, voffB);
            PG8_BAR; PG8_WAIT_L(0); PG8_MMA(0, 1, At, B1); PG8_BAR;
            PG8_LDA(At, 0, 1); PG8_STAGE(PG8_SA(0, 0), a2, voffA);
            PG8_BAR; PG8_WAIT_L(0); PG8_MMA(1, 0, At, B0); PG8_BAR; PG8_SCHED;
            PG8_STAGE(PG8_SB(0, 1), b2 + hstep, voffB);
            PG8_WAIT_V(6); PG8_BAR; PG8_MMA(1, 1, At, B1); PG8_BAR;
            PG8_LDB(B0, 1, 0); PG8_SCHED; PG8_LDA(At, 1, 0); PG8_STAGE(PG8_SA(0, 1), a2 + hstep, voffA);
            PG8_WAIT_L(8); PG8_BAR; PG8_WAIT_L(0); PG8_MMA(0, 0, At, B0); PG8_BAR; PG8_SCHED;
            PG8_LDB(B1, 1, 1); PG8_STAGE(PG8_SB(1, 0), b3, voffB);
            PG8_BAR; PG8_WAIT_L(0); PG8_MMA(0, 1, At, B1); PG8_BAR;
            PG8_LDA(At, 1, 1); PG8_STAGE(PG8_SA(1, 0), a3, voffA);
            PG8_BAR; PG8_WAIT_L(0); PG8_MMA(1, 0, At, B0); PG8_BAR; PG8_SCHED;
            PG8_STAGE(PG8_SB(1, 1), b3 + hstep, voffB);
            PG8_WAIT_V(6); PG8_BAR; PG8_MMA(1, 1, At, B1); PG8_BAR;
            }
        }
        if constexpr (ALIGN_EPI) { if (wr == 0) PG8_BAR; }
        if constexpr (!Epi::AFTER_DRAIN) { E(acc, cur, wr, wc, fr, fq); S.done(cur); }
        if (!has_next) break;
#pragma unroll
        for (int a = 0; a < 2; ++a)
#pragma unroll
            for (int b = 0; b < 2; ++b)
#pragma unroll
                for (int m = 0; m < 4; ++m)
#pragma unroll
                    for (int n = 0; n < 2; ++n) acc[a][b][m][n] = (f32x4){0.f, 0.f, 0.f, 0.f};
        cur = nxt; cA = nA; cB = nB; ++ui;
        if constexpr (ALIGN_EPI) { if (wr == 1) PG8_BAR; }
    }
    PG8_WAIT_V(0);
    if constexpr (!ALIGN_EPI) { if (wr == 0) PG8_BAR; }
    PG8_BAR;
    if constexpr (Epi::AFTER_DRAIN) { E.fused(acc, cur, wr, wc, fr, fq, lds, wid, lane); S.done(cur); }
#undef PG8_SA
#undef PG8_SB
#undef PG8_STAGE
#undef PG8_LDA
#undef PG8_LDB
#undef PG8_MMA
#undef PG8_WAIT_V
#undef PG8_WAIT_L
#undef PG8_BAR
#undef PG8_SCHED
}
}
#define LAS __attribute__((address_space(3)))
typedef unsigned short bf16;
typedef short bf16x8 __attribute__((ext_vector_type(8)));
typedef short s16x4 __attribute__((ext_vector_type(4)));
typedef float f32x4 __attribute__((ext_vector_type(4)));
typedef float f32x2 __attribute__((ext_vector_type(2)));
typedef float f32x16 __attribute__((ext_vector_type(16)));
typedef unsigned v4u __attribute__((ext_vector_type(4)));
typedef unsigned v2u __attribute__((ext_vector_type(2)));
constexpr int D = 1024, SEQ = 16384, NSMP = 32, MP = 16640, DIN = 3584, FF = 4096;
constexpr int CQA = 0, CKA = 512, CVA = 1024, CQR = 1536, CKR = 2048, CVR = 2560, CGR = 3072;
constexpr int NCH = 128, CH = 128, WIN = 2048;
constexpr float ALPHA = 1.1892071150027210667f, LN_EPS = 1e-5f, GN_EPS = 1e-6f;
constexpr int NWAVES = 8, NTHR = 512;
constexpr int LDS_BYTES = 147456;
constexpr size_t MiB = 1u << 20;
constexpr size_t WS_CTL = 0, CTL_ZERO_BYTES = 1 * MiB;
constexpr size_t WS_WIN = 2 * MiB, WS_WOUT = 10 * MiB, WS_WUP = 12 * MiB, WS_WDN = 20 * MiB;
constexpr size_t WS_ROPE = 28 * MiB, WS_BIAS = 37 * MiB, WS_XB = 38 * MiB, WS_U = 71 * MiB, WS_HEADS = 185 * MiB;
constexpr size_t WS_AT = 218 * MiB, WS_ST = 250 * MiB, WS_MIX = 266 * MiB, WS_X1 = 331 * MiB, WS_X1B = 396 * MiB, WS_H = 429 * MiB, WS_F = 559 * MiB, WS_END = 624 * MiB;
constexpr size_t O_YP = 0, O_YS = 16777216, O_KVP = 16809984, O_KVS = 18907136, O_STP = 18939904, O_STS = 19005440, O_END = 21102592;

struct Params {
    const float *x_prompt, *x_sample, *cache, *state, *w_in, *rel_bias, *w_out, *ln1_g, *ln1_b, *w_up, *w_down, *ln2_g, *ln2_b;
    float* out; unsigned char* ws; int ph_lo, ph_hi;
};

__device__ __forceinline__ unsigned f2bf(float f) { unsigned u = __builtin_bit_cast(unsigned, f); return (u + 0x7fffu + ((u >> 16) & 1u)) >> 16; }
__device__ __forceinline__ unsigned pk2(float lo, float hi) { return f2bf(lo) | (f2bf(hi) << 16); }
__device__ __forceinline__ float bf2f(unsigned short b) { return __builtin_bit_cast(float, (unsigned)b << 16); }
__device__ __forceinline__ float bflo(unsigned w) { return __builtin_bit_cast(float, w << 16); }
__device__ __forceinline__ float bfhi(unsigned w) { return __builtin_bit_cast(float, w & 0xffff0000u); }
#define MFMA16(a, b, c) __builtin_amdgcn_mfma_f32_16x16x32_bf16((a), (b), (c), 0, 0, 0)
#define MFMA32(a, b, c) __builtin_amdgcn_mfma_f32_32x32x16_bf16((a), (b), (c), 0, 0, 0)
__device__ __forceinline__ float log2_gamma(int h) { return log2f(1.0f - exp2f(-5.0f - (float)h)); }

__device__ __forceinline__ void p0_transpose_item(const float* W, int K, int N, bf16* WT, LAS float* scr, int item, int lane) {
    const int nblk = N / 32, kb = item / nblk, nb = item % nblk, k0 = 64 * kb, n0 = 32 * nb;
#pragma unroll 8
    for (int i = 0; i < 32; ++i) { const int kk = 2 * i + (lane >> 5); scr[kk * 33 + (lane & 31)] = W[(size_t)(k0 + kk) * N + n0 + (lane & 31)]; }
    asm volatile("s_waitcnt lgkmcnt(0)" ::: "memory");
    const int c = lane & 7;
#pragma unroll
    for (int j = 0; j < 4; ++j) { const int n = (lane >> 3) + 8 * j; const LAS float* s = scr + (8 * c) * 33 + n;
        v4u o; o.x = pk2(s[0 * 33], s[1 * 33]); o.y = pk2(s[2 * 33], s[3 * 33]); o.z = pk2(s[4 * 33], s[5 * 33]); o.w = pk2(s[6 * 33], s[7 * 33]);
        *(v4u*)(WT + (size_t)(n0 + n) * K + k0 + 8 * c) = o; }
    asm volatile("s_waitcnt lgkmcnt(0)" ::: "memory");
}
__device__ __forceinline__ int t5_bucket(int dist) {
    if (dist < 16) return dist;
    int b = 16 + (int)(log((double)dist / 16.0) / log(128.0) * 16.0);
    return b < 31 ? b : 31;
}
__device__ __forceinline__ void phase_prep(const Params& P, LAS unsigned char* lds) {
    const int tid = threadIdx.x, lane = tid & 63, wave = tid >> 6;
    const int gw = blockIdx.x * NWAVES + wave, NGW = gridDim.x * NWAVES;
    LAS float* scr = (LAS float*)(lds + wave * 16384);
    bf16* WinT = (bf16*)(P.ws + WS_WIN); bf16* WoutT = (bf16*)(P.ws + WS_WOUT); bf16* WupT = (bf16*)(P.ws + WS_WUP); bf16* WdnT = (bf16*)(P.ws + WS_WDN);
    constexpr int I_IN = (D / 64) * (DIN / 32), I_OUT = (D / 64) * (D / 32), I_UP = (D / 64) * (FF / 32), I_DN = (FF / 64) * (D / 32);
    constexpr int NITEMS = I_IN + I_OUT + I_UP + I_DN;
    for (int it = gw; it < NITEMS; it += NGW) {
        int r = it;
        if (r < I_IN) { p0_transpose_item(P.w_in, D, DIN, WinT, scr, r, lane); continue; } r -= I_IN;
        if (r < I_OUT) { p0_transpose_item(P.w_out, D, D, WoutT, scr, r, lane); continue; } r -= I_OUT;
        if (r < I_UP) { p0_transpose_item(P.w_up, D, FF, WupT, scr, r, lane); continue; } r -= I_UP;
        p0_transpose_item(P.w_down, FF, D, WdnT, scr, r, lane);
    }
    bf16* XB = (bf16*)(P.ws + WS_XB);
    for (int m = gw; m < MP; m += NGW) {
        const float* src = m < SEQ ? P.x_prompt + (size_t)m * D : (m < SEQ + NSMP ? P.x_sample + (size_t)(m - SEQ) * D : nullptr);
        unsigned long long* o8 = (unsigned long long*)(XB + (size_t)m * D) + lane;
#pragma unroll
        for (int j = 0; j < 4; ++j) { f32x4 v = src ? ((const f32x4*)src)[lane + 64 * j] : (f32x4){0.f, 0.f, 0.f, 0.f};
            o8[64 * j] = (unsigned long long)pk2(v.x, v.y) | ((unsigned long long)pk2(v.z, v.w) << 32); }
    }
    f32x2* rope = (f32x2*)(P.ws + WS_ROPE);
    const int gt = blockIdx.x * NTHR + tid, NGT = gridDim.x * NTHR;
    for (int e = gt; e < (SEQ + 1) * 64; e += NGT) { const int pos = e >> 6, i = e & 63;
        const double inv = exp(-(double)i / 63.0 * 9.210340371976184); const double ang = (double)pos * inv;
        rope[e] = (f32x2){(float)cos(ang), (float)sin(ang)}; }
    float* biasT = (float*)(P.ws + WS_BIAS);
    for (int e = gt; e < 3 * 8 * 132; e += NGT) { const int b = e / (8 * 132), h = (e / 132) % 8, rel = e % 132; const int dil = b == 0 ? 1 : (b == 1 ? 4 : 16);
        biasT[e] = rel <= 128 ? P.rel_bias[t5_bucket(rel * dil) * 8 + h] : 0.f; }
}

__device__ __forceinline__ void attn_prompt_unit(const bf16* U, const float* biasT, bf16* HEADS, int h, int r, int ig, int lane) {
    const int a = lane & 15, g = lane >> 4, i0 = ig * 16;
    const int pq = r + 16 * (i0 + a);
    const bf16* qrow = U + (size_t)pq * DIN + CQA + h * 64;
    bf16x8 qf[2]; qf[0] = *(const bf16x8*)(qrow + 8 * g); qf[1] = *(const bf16x8*)(qrow + 32 + 8 * g);
    float m_run = -INFINITY, l_run = 0.f;
    f32x4 o[4];
#pragma unroll
    for (int dt = 0; dt < 4; ++dt) o[dt] = (f32x4){0.f, 0.f, 0.f, 0.f};
    for (int b = 0; b < 3; ++b) {
        const int dil = b == 0 ? 1 : (b == 1 ? 4 : 16), qa = 16 / dil;
        const int nt = (128 + 15 * qa + 1 + 15) / 16, npair = (nt + 1) / 2;
        const int kbase = r + 16 * i0 - 128 * dil;
        const float* bt = biasT + (b * 8 + h) * 132;
        for (int pr = 0; pr < npair; ++pr) {
            f32x4 s[2];
#pragma unroll
            for (int ti = 0; ti < 2; ++ti) {
                const int tA = 16 * (2 * pr + ti) + a;
                int kp = kbase + dil * tA; kp = kp < 0 ? 0 : (kp > SEQ - 1 ? SEQ - 1 : kp);
                const bf16* krow = U + (size_t)kp * DIN + CKA + h * 64;
                const bf16x8 k0 = *(const bf16x8*)(krow + 8 * g), k1 = *(const bf16x8*)(krow + 32 + 8 * g);
                f32x4 acc = (f32x4){0.f, 0.f, 0.f, 0.f};
                acc = MFMA16(k0, qf[0], acc); acc = MFMA16(k1, qf[1], acc);
#pragma unroll
                for (int reg = 0; reg < 4; ++reg) {
                    const int t = 16 * (2 * pr + ti) + 4 * g + reg, rel = qa * a + 128 - t, kpos = kbase + dil * t;
                    const bool valid = (rel >= 0) && (rel <= 128) && (kpos >= 0);
                    acc[reg] = valid ? acc[reg] * 0.125f + bt[valid ? rel : 0] : -INFINITY;
                }
                s[ti] = acc;
            }
            float tmax = fmaxf(fmaxf(fmaxf(s[0][0], s[0][1]), fmaxf(s[0][2], s[0][3])), fmaxf(fmaxf(s[1][0], s[1][1]), fmaxf(s[1][2], s[1][3])));
            tmax = fmaxf(tmax, __shfl_xor(tmax, 16)); tmax = fmaxf(tmax, __shfl_xor(tmax, 32));
            const float m_new = fmaxf(m_run, tmax), m_use = (m_new == -INFINITY) ? 0.f : m_new;
            const float alpha = __expf(m_run - m_use);
            float p[8]; float psum = 0.f;
#pragma unroll
            for (int j = 0; j < 8; ++j) { p[j] = __expf(s[j >> 2][j & 3] - m_use); psum += p[j]; }
            l_run = l_run * alpha + psum; m_run = m_new;
            v4u pw; pw.x = pk2(p[0], p[1]); pw.y = pk2(p[2], p[3]); pw.z = pk2(p[4], p[5]); pw.w = pk2(p[6], p[7]);
            const bf16x8 pf = __builtin_bit_cast(bf16x8, pw);
            int kpv[8];
#pragma unroll
            for (int j = 0; j < 8; ++j) { const int t = 16 * (2 * pr + (j >> 2)) + 4 * g + (j & 3); int kp = kbase + dil * t; kpv[j] = kp < 0 ? 0 : (kp > SEQ - 1 ? SEQ - 1 : kp); }
#pragma unroll
            for (int dt = 0; dt < 4; ++dt) {
                bf16x8 vf;
#pragma unroll
                for (int j = 0; j < 8; ++j) vf[j] = (short)U[(size_t)kpv[j] * DIN + CVA + h * 64 + 16 * dt + a];
                o[dt] = o[dt] * alpha;
                o[dt] = MFMA16(vf, pf, o[dt]);
            }
        }
    }
    float l_tot = l_run + __shfl_xor(l_run, 16); l_tot += __shfl_xor(l_tot, 32);
    const float inv = 1.0f / l_tot;
    bf16* orow = HEADS + (size_t)pq * D + h * 64 + 4 * g;
#pragma unroll
    for (int dt = 0; dt < 4; ++dt) { v2u w; w.x = pk2(o[dt][0] * inv, o[dt][1] * inv); w.y = pk2(o[dt][2] * inv, o[dt][3] * inv); *(v2u*)(orow + 16 * dt) = w; }
}
__device__ __forceinline__ void attn_sample_unit(const Params& P, const bf16* U, const float* biasT, bf16* HEADS, int bb, int h, int lane) {
    const int sub = lane & 3, quad = lane >> 2;
    const bf16* urow = U + (size_t)(SEQ + bb) * DIN;
    float q[16];
#pragma unroll
    for (int i = 0; i < 16; ++i) q[i] = bf2f(urow[CQA + h * 64 + 16 * sub + i]);
    float m_run = -INFINITY, l_run = 0.f, o[16];
#pragma unroll
    for (int i = 0; i < 16; ++i) o[i] = 0.f;
    for (int it = 0; it < 25; ++it) {
        const int e = it * 16 + quad; const bool valid = e < 387;
        const int ee = valid ? e : 0, br = ee / 129, j = ee % 129, dil = br == 0 ? 1 : (br == 1 ? 4 : 16);
        float kk[16], vv[16];
        if (j == 0) {
#pragma unroll
            for (int i = 0; i < 16; ++i) { kk[i] = bf2f(urow[CKA + h * 64 + 16 * sub + i]); vv[i] = bf2f(urow[CVA + h * 64 + 16 * sub + i]); }
        } else {
            const float* crow = P.cache + ((size_t)(bb * WIN + (WIN - j * dil)) * 2) * 512 + h * 64 + 16 * sub;
#pragma unroll
            for (int i4 = 0; i4 < 4; ++i4) { const f32x4 kx = *(const f32x4*)(crow + 4 * i4), vx = *(const f32x4*)(crow + 512 + 4 * i4);
                kk[4 * i4] = kx.x; kk[4 * i4 + 1] = kx.y; kk[4 * i4 + 2] = kx.z; kk[4 * i4 + 3] = kx.w; vv[4 * i4] = vx.x; vv[4 * i4 + 1] = vx.y; vv[4 * i4 + 2] = vx.z; vv[4 * i4 + 3] = vx.w; }
        }
        float s = 0.f;
#pragma unroll
        for (int i = 0; i < 16; ++i) s += q[i] * kk[i];
        s += __shfl_xor(s, 1); s += __shfl_xor(s, 2);
        s = valid ? s * 0.125f + biasT[(br * 8 + h) * 132 + j] : -INFINITY;
        const float m_new = fmaxf(m_run, s), m_use = (m_new == -INFINITY) ? 0.f : m_new;
        const float alpha = __expf(m_run - m_use), p = __expf(s - m_use);
        l_run = l_run * alpha + p; m_run = m_new;
#pragma unroll
        for (int i = 0; i < 16; ++i) o[i] = o[i] * alpha + p * vv[i];
    }
    float M = m_run;
#pragma unroll
    for (int sft = 4; sft < 64; sft <<= 1) M = fmaxf(M, __shfl_xor(M, sft));
    const float f = __expf(m_run - M);
    l_run *= f;
#pragma unroll
    for (int i = 0; i < 16; ++i) o[i] *= f;
#pragma unroll
    for (int sft = 4; sft < 64; sft <<= 1) { l_run += __shfl_xor(l_run, sft);
#pragma unroll
        for (int i = 0; i < 16; ++i) o[i] += __shfl_xor(o[i], sft); }
    if (quad == 0) { const float inv = 1.0f / l_run; bf16* orow = HEADS + (size_t)(SEQ + bb) * D + h * 64 + 16 * sub;
#pragma unroll
        for (int i = 0; i < 16; i += 2) *(unsigned*)(orow + i) = pk2(o[i] * inv, o[i + 1] * inv); }
}
__device__ __forceinline__ void phase_attn(const Params& P) {
    const int tid = threadIdx.x, lane = tid & 63, wave = tid >> 6;
    const int gw = blockIdx.x * NWAVES + wave, NGW = gridDim.x * NWAVES;
    const bf16* U = (const bf16*)(P.ws + WS_U); const float* biasT = (const float*)(P.ws + WS_BIAS); bf16* HEADS = (bf16*)(P.ws + WS_HEADS);
    for (int it = gw; it < 256 + 8192; it += NGW) {
        if (it < 256) { attn_sample_unit(P, U, biasT, HEADS, it >> 3, it & 7, lane); continue; }
        const int u = it - 256; const int h = u & 7, r = (u >> 3) & 15, ig = u >> 7;
        attn_prompt_unit(U, biasT, HEADS, h, r, ig, lane);
    }
}
constexpr int RP = 136;
template <bool KT, bool DECAY>
__device__ __forceinline__ void ret_stage_k(const bf16* U, const f32x2* rope, LAS bf16* dst, int c, int h, float l2g, int tid) {
#pragma unroll
    for (int i2 = 0; i2 < 2; ++i2) {
        const int q = tid + NTHR * i2, nn = q >> 3, ic = q & 7, n = c * CH + nn;
        const bf16* kr = U + (size_t)n * DIN + CKR + h * 128 + 8 * ic;
        const v4u k1 = *(const v4u*)kr, k2 = *(const v4u*)(kr + 64);
        const f32x2* tb = rope + (size_t)n * 64 + 8 * ic;
        const float sc = 0.08838834764831845f * (DECAY ? exp2f((float)(127 - nn) * l2g) : 1.0f);
        float r1[8], r2[8];
#pragma unroll
        for (int e = 0; e < 8; ++e) { const unsigned w1 = k1[e >> 1], w2 = k2[e >> 1]; const float a = (e & 1) ? bfhi(w1) : bflo(w1), b = (e & 1) ? bfhi(w2) : bflo(w2);
            const f32x2 cs = tb[e]; r1[e] = (a * cs.x - b * cs.y) * sc; r2[e] = (a * cs.y + b * cs.x) * sc; }
        if (KT) {
#pragma unroll
            for (int e = 0; e < 8; ++e) { dst[(8 * ic + e) * RP + nn] = (bf16)f2bf(r1[e]); dst[(64 + 8 * ic + e) * RP + nn] = (bf16)f2bf(r2[e]); }
        } else {
            v4u o1, o2;
#pragma unroll
            for (int e = 0; e < 4; ++e) { o1[e] = pk2(r1[2 * e], r1[2 * e + 1]); o2[e] = pk2(r2[2 * e], r2[2 * e + 1]); }
            *(LAS v4u*)(dst + nn * RP + 8 * ic) = o1; *(LAS v4u*)(dst + nn * RP + 64 + 8 * ic) = o2;
        }
    }
}
__device__ __forceinline__ void ret_stage_vt(const bf16* U, LAS bf16* dst, int c, int h, int tid) {
#pragma unroll
    for (int i = 0; i < 4; ++i) {
        const int q = tid + NTHR * i, nn = q >> 4, vc = q & 15, n = c * CH + nn;
        const v4u v = *(const v4u*)(U + (size_t)n * DIN + CVR + h * 128 + 8 * vc);
#pragma unroll
        for (int e = 0; e < 8; ++e) { const unsigned w = v[e >> 1]; dst[(8 * vc + e) * RP + nn] = (bf16)((e & 1) ? (w >> 16) : (w & 0xffffu)); }
    }
}
__device__ __forceinline__ void phase_ret_r1(const Params& P, LAS unsigned char* lds) {
    const int tid = threadIdx.x, lane = tid & 63, wave = tid >> 6;
    const bf16* U = (const bf16*)(P.ws + WS_U); const f32x2* rope = (const f32x2*)(P.ws + WS_ROPE); float* AT = (float*)(P.ws + WS_AT);
    LAS bf16* Kt = (LAS bf16*)lds; LAS bf16* Vt = (LAS bf16*)(lds + 128 * RP * 2);
    const int r = lane & 31, hh = lane >> 5, vt = wave & 3, dt0 = 2 * (wave >> 2);
    for (int it = blockIdx.x; it < NCH * 4; it += gridDim.x) {
        const int c = it >> 2, h = it & 3; const float l2g = log2_gamma(h);
        __syncthreads();
        ret_stage_k<true, true>(U, rope, Kt, c, h, l2g, tid);
        ret_stage_vt(U, Vt, c, h, tid);
        __syncthreads();
        f32x16 acc[2];
#pragma unroll
        for (int j = 0; j < 2; ++j)
#pragma unroll
            for (int i = 0; i < 16; ++i) acc[j][i] = 0.f;
#pragma unroll
        for (int ks = 0; ks < 8; ++ks) {
            const bf16x8 af = *(const LAS bf16x8*)(Vt + (32 * vt + r) * RP + 16 * ks + 8 * hh);
#pragma unroll
            for (int j = 0; j < 2; ++j) { const bf16x8 bfr = *(const LAS bf16x8*)(Kt + (32 * (dt0 + j) + r) * RP + 16 * ks + 8 * hh); acc[j] = MFMA32(af, bfr, acc[j]); }
        }
        float* dst = AT + (size_t)(c * 4 + h) * 16384;
#pragma unroll
        for (int j = 0; j < 2; ++j)
#pragma unroll
            for (int reg = 0; reg < 16; ++reg) { const int v = 32 * vt + (reg & 3) + 8 * (reg >> 2) + 4 * hh; dst[v * 128 + 32 * (dt0 + j) + r] = acc[j][reg]; }
    }
}
__device__ __forceinline__ void phase_ret_r2(const Params& P) {
    const int e = blockIdx.x * NTHR + threadIdx.x;
    if (e < 4 * 16384) {
    const int h = e >> 14, vd = e & 16383, v = vd >> 7, d = vd & 127;
    const float* AT = (const float*)(P.ws + WS_AT) + h * 16384 + vd; bf16* ST = (bf16*)(P.ws + WS_ST) + h * 16384 + vd;
    const float gC = exp2f(128.0f * log2_gamma(h));
    float S = 0.f;
#pragma unroll 8
    for (int c = 0; c < NCH; ++c) { ST[(size_t)c * 65536] = (bf16)f2bf(S); S = gC * S + AT[(size_t)c * 65536]; }
    P.out[O_STP + (size_t)(h * 128 + d) * 128 + v] = S;
    }
}
__device__ __forceinline__ void phase_ret_r3(const Params& P, LAS unsigned char* lds) {
    const int tid = threadIdx.x, lane = tid & 63, wave = tid >> 6, a = lane & 15, g = lane >> 4;
    const bf16* U = (const bf16*)(P.ws + WS_U); const f32x2* rope = (const f32x2*)(P.ws + WS_ROPE); const bf16* ST = (const bf16*)(P.ws + WS_ST); bf16* HEADS = (bf16*)(P.ws + WS_HEADS);
    LAS bf16* Kn = (LAS bf16*)lds; LAS bf16* Vt = (LAS bf16*)(lds + 128 * RP * 2);
    for (int it = blockIdx.x; it < NCH * 4; it += gridDim.x) {
        const int c = it >> 2, h = it & 3; const float l2g = log2_gamma(h);
        __syncthreads();
        ret_stage_k<false, false>(U, rope, Kn, c, h, l2g, tid);
        ret_stage_vt(U, Vt, c, h, tid);
        __syncthreads();
        const int nl = 16 * wave + a, n = c * CH + nl;
        bf16x8 qf[4];
        { const bf16* qr = U + (size_t)n * DIN + CQR + h * 128 + 8 * g;
#pragma unroll
          for (int dp = 0; dp < 2; ++dp) { const v4u q1 = *(const v4u*)(qr + 32 * dp), q2 = *(const v4u*)(qr + 64 + 32 * dp); const f32x2* tb = rope + (size_t)n * 64 + 32 * dp + 8 * g;
              float r1[8], r2[8];
#pragma unroll
              for (int e = 0; e < 8; ++e) { const unsigned w1 = q1[e >> 1], w2 = q2[e >> 1]; const float x1 = (e & 1) ? bfhi(w1) : bflo(w1), x2 = (e & 1) ? bfhi(w2) : bflo(w2);
                  const f32x2 cs = tb[e]; r1[e] = x1 * cs.x - x2 * cs.y; r2[e] = x1 * cs.y + x2 * cs.x; }
              v4u o1, o2;
#pragma unroll
              for (int e = 0; e < 4; ++e) { o1[e] = pk2(r1[2 * e], r1[2 * e + 1]); o2[e] = pk2(r2[2 * e], r2[2 * e + 1]); }
              qf[dp] = __builtin_bit_cast(bf16x8, o1); qf[dp + 2] = __builtin_bit_cast(bf16x8, o2); } }
        f32x4 o[8];
#pragma unroll
        for (int vt = 0; vt < 8; ++vt) o[vt] = (f32x4){0.f, 0.f, 0.f, 0.f};
        const bf16* st = ST + (size_t)(c * 4 + h) * 16384;
#pragma unroll
        for (int vt = 0; vt < 8; ++vt)
#pragma unroll
            for (int ds = 0; ds < 4; ++ds) { const bf16x8 af = *(const bf16x8*)(st + (16 * vt + a) * 128 + 32 * ds + 8 * g); o[vt] = MFMA16(af, qf[ds], o[vt]); }
        const float cdec = exp2f((float)(nl + 1) * l2g);
#pragma unroll
        for (int vt = 0; vt < 8; ++vt) o[vt] = o[vt] * cdec;
        for (int mp = 0; mp <= (wave >> 1); ++mp) {
            float p[8];
#pragma unroll
            for (int ti = 0; ti < 2; ++ti) {
                const int mt = 2 * mp + ti; f32x4 acc = (f32x4){0.f, 0.f, 0.f, 0.f};
#pragma unroll
                for (int ds = 0; ds < 4; ++ds) { const bf16x8 kf = *(const LAS bf16x8*)(Kn + (16 * mt + a) * RP + 32 * ds + 8 * g); acc = MFMA16(kf, qf[ds], acc); }
#pragma unroll
                for (int reg = 0; reg < 4; ++reg) { const int m = 16 * mt + 4 * g + reg; p[4 * ti + reg] = (nl >= m) ? acc[reg] * exp2f((float)(nl - m) * l2g) : 0.f; }
            }
            v4u pw; pw.x = pk2(p[0], p[1]); pw.y = pk2(p[2], p[3]); pw.z = pk2(p[4], p[5]); pw.w = pk2(p[6], p[7]);
            const bf16x8 pf = __builtin_bit_cast(bf16x8, pw);
#pragma unroll
            for (int vt = 0; vt < 8; ++vt) {
                const LAS bf16* vr = Vt + (16 * vt + a) * RP + 32 * mp + 4 * g;
                const v2u lo = *(const LAS v2u*)vr, hi = *(const LAS v2u*)(vr + 16);
                v4u vw; vw.x = lo.x; vw.y = lo.y; vw.z = hi.x; vw.w = hi.y;
                o[vt] = MFMA16(__builtin_bit_cast(bf16x8, vw), pf, o[vt]);
            }
        }
        float s1 = 0.f;
#pragma unroll
        for (int vt = 0; vt < 8; ++vt) s1 += (o[vt][0] + o[vt][1]) + (o[vt][2] + o[vt][3]);
        s1 += __shfl_xor(s1, 16); s1 += __shfl_xor(s1, 32);
        const float mean = s1 * (1.0f / 128.0f); float s2 = 0.f;
#pragma unroll
        for (int vt = 0; vt < 8; ++vt) { const f32x4 dd = o[vt] - mean; s2 += (dd[0] * dd[0] + dd[1] * dd[1]) + (dd[2] * dd[2] + dd[3] * dd[3]); }
        s2 += __shfl_xor(s2, 16); s2 += __shfl_xor(s2, 32);
        const float rstd = 1.0f / sqrtf(s2 * (1.0f / 128.0f) + GN_EPS);
        const bf16* gr = U + (size_t)n * DIN + CGR + h * 128 + 4 * g; bf16* orow = HEADS + (size_t)n * D + 512 + h * 128 + 4 * g;
#pragma unroll
        for (int vt = 0; vt < 8; ++vt) { const v2u gw = *(const v2u*)(gr + 16 * vt); float gv[4] = {bflo(gw.x), bfhi(gw.x), bflo(gw.y), bfhi(gw.y)}; float y[4];
#pragma unroll
            for (int e = 0; e < 4; ++e) { const float sg = gv[e] / (1.0f + __expf(-gv[e])); y[e] = sg * (o[vt][e] - mean) * rstd; }
            v2u w; w.x = pk2(y[0], y[1]); w.y = pk2(y[2], y[3]); *(v2u*)(orow + 16 * vt) = w; }
    }
}
__device__ __forceinline__ void phase_ret_sample(const Params& P, LAS unsigned char* lds) {
    const int tid = threadIdx.x;
    const bf16* U = (const bf16*)(P.ws + WS_U); const f32x2* rope = (const f32x2*)(P.ws + WS_ROPE); bf16* HEADS = (bf16*)(P.ws + WS_HEADS);
    LAS float* qt = (LAS float*)lds; LAS float* kt = qt + 128; LAS float* part = kt + 128; LAS float* red = part + 512;
    for (int it = blockIdx.x; it < NSMP * 4; it += gridDim.x) {
        const int bb = it >> 2, h = it & 3; const float gam = 1.0f - exp2f(-5.0f - (float)h);
        const bf16* urow = U + (size_t)(SEQ + bb) * DIN;
        __syncthreads();
        if (tid < 64) { const f32x2 cs = rope[(size_t)SEQ * 64 + tid];
            const float q1 = bf2f(urow[CQR + h * 128 + tid]), q2 = bf2f(urow[CQR + h * 128 + 64 + tid]), k1 = bf2f(urow[CKR + h * 128 + tid]), k2 = bf2f(urow[CKR + h * 128 + 64 + tid]);
            qt[tid] = q1 * cs.x - q2 * cs.y; qt[tid + 64] = q1 * cs.y + q2 * cs.x;
            kt[tid] = (k1 * cs.x - k2 * cs.y) * 0.08838834764831845f; kt[tid + 64] = (k1 * cs.y + k2 * cs.x) * 0.08838834764831845f; }
        __syncthreads();
        const int v = tid & 127, dq = tid >> 7;
        const float vv = bf2f(urow[CVR + h * 128 + v]);
        const float* sin_ = P.state + (size_t)(bb * 4 + h) * 16384; float* sout = P.out + O_STS + (size_t)(bb * 4 + h) * 16384;
        float acc = 0.f;
#pragma unroll 8
        for (int dd = 0; dd < 32; ++dd) { const int d = 32 * dq + dd; const float s = sin_[d * 128 + v]; acc += qt[d] * s; sout[d * 128 + v] = gam * s + kt[d] * vv; }
        part[dq * 128 + v] = acc;
        if (tid < 64) { float qk = qt[tid] * kt[tid] + qt[tid + 64] * kt[tid + 64];
#pragma unroll
            for (int sft = 1; sft < 64; sft <<= 1) qk += __shfl_xor(qk, sft);
            if (tid == 0) red[0] = qk; }
        __syncthreads();
        float o = 0.f;
        if (tid < 128) { o = gam * (part[v] + part[128 + v] + part[256 + v] + part[384 + v]) + red[0] * vv;
            float s1 = o;
#pragma unroll
            for (int sft = 1; sft < 64; sft <<= 1) s1 += __shfl_xor(s1, sft);
            if ((tid & 63) == 0) red[2 + (tid >> 6)] = s1; }
        __syncthreads();
        const float mean = (red[2] + red[3]) * (1.0f / 128.0f);
        if (tid < 128) { const float dlt = o - mean; float s2 = dlt * dlt;
#pragma unroll
            for (int sft = 1; sft < 64; sft <<= 1) s2 += __shfl_xor(s2, sft);
            if ((tid & 63) == 0) red[4 + (tid >> 6)] = s2; }
        __syncthreads();
        if (tid < 128) { const float rstd = 1.0f / sqrtf((red[4] + red[5]) * (1.0f / 128.0f) + GN_EPS); const float gv = bf2f(urow[CGR + h * 128 + v]);
            HEADS[(size_t)(SEQ + bb) * D + 512 + h * 128 + v] = (bf16)f2bf(gv / (1.0f + __expf(-gv)) * (o - mean) * rstd); }
    }
}
__device__ __forceinline__ void ln_rows(const Params& P, int which) {
    const int tid = threadIdx.x, lane = tid & 63, wave = tid >> 6;
    const int gw = blockIdx.x * NWAVES + wave, NGW = gridDim.x * NWAVES;
    const float* gam = which == 0 ? P.ln1_g : P.ln2_g; const float* bet = which == 0 ? P.ln1_b : P.ln2_b;
    const float* add = (const float*)(P.ws + (which == 0 ? WS_MIX : WS_F));
    float* X1 = (float*)(P.ws + WS_X1); bf16* X1B = (bf16*)(P.ws + WS_X1B);
    for (int m = gw; m < SEQ + NSMP; m += NGW) {
        const float* res = which == 0 ? (m < SEQ ? P.x_prompt + (size_t)m * D : P.x_sample + (size_t)(m - SEQ) * D) : X1 + (size_t)m * D;
        const f32x4* rr = (const f32x4*)res + lane; const f32x4* aa = (const f32x4*)(add + (size_t)m * D) + lane;
        f32x4 v[4]; float s = 0.f;
#pragma unroll
        for (int j = 0; j < 4; ++j) { v[j] = rr[64 * j] * ALPHA + aa[64 * j]; s += (v[j].x + v[j].y) + (v[j].z + v[j].w); }
#pragma unroll
        for (int sft = 1; sft < 64; sft <<= 1) s += __shfl_xor(s, sft);
        const float mean = s * (1.0f / D); float s2 = 0.f;
#pragma unroll
        for (int j = 0; j < 4; ++j) { v[j] = v[j] - mean; s2 += (v[j].x * v[j].x + v[j].y * v[j].y) + (v[j].z * v[j].z + v[j].w * v[j].w); }
#pragma unroll
        for (int sft = 1; sft < 64; sft <<= 1) s2 += __shfl_xor(s2, sft);
        const float rstd = 1.0f / sqrtf(s2 * (1.0f / D) + LN_EPS);
        float* of = which == 0 ? X1 + (size_t)m * D : (m < SEQ ? P.out + O_YP + (size_t)m * D : P.out + O_YS + (size_t)(m - SEQ) * D);
#pragma unroll
        for (int j = 0; j < 4; ++j) { const f32x4 gg = ((const f32x4*)gam)[lane + 64 * j], bb = ((const f32x4*)bet)[lane + 64 * j]; const f32x4 y = v[j] * rstd * gg + bb;
            ((f32x4*)of)[lane + 64 * j] = y;
            if (which == 0) ((unsigned long long*)(X1B + (size_t)m * D))[lane + 64 * j] = (unsigned long long)pk2(y.x, y.y) | ((unsigned long long)pk2(y.z, y.w) << 32); }
    }
}
constexpr int NPHASE = 10;
__global__ void __launch_bounds__(NTHR, 2) fwd_kernel(Params P) {
    extern __shared__ __attribute__((aligned(16))) unsigned char lds_raw[];
    LAS unsigned char* lds = (LAS unsigned char*)lds_raw;
    cg::grid_group grid = cg::this_grid();
    const int lo = P.ph_lo, hi = P.ph_hi;
#define IN(k) (lo <= (k) && (k) < hi)
#define SEAM(k) do { if (IN(k) && IN((k) + 1)) grid.sync(); } while (0)
    if (IN(0)) phase_prep(P, lds);
    SEAM(0);
    if (IN(1)) {
        pg8::Gemm g{(const pg8::bf16_t*)(P.ws + WS_XB), (const pg8::bf16_t*)(P.ws + WS_WIN), MP, DIN, D};
        pg8::StaticOrder S; S.init(MP, DIN, gridDim.x, blockIdx.x);
        pg8::EpiU E{(pg8::bf16_t*)(P.ws + WS_U), DIN, P.out + O_KVP, P.out + O_KVS};
        pg8::gemm_phase<pg8::EpiU, pg8::StaticOrder, true, true>(lds, g, S, E);
    }
    SEAM(1);
    if (IN(2)) { phase_attn(P); phase_ret_r1(P, lds); phase_ret_sample(P, lds); }
    SEAM(2);
    if (IN(3)) phase_ret_r2(P);
    SEAM(3);
    if (IN(4)) phase_ret_r3(P, lds);
    SEAM(4);
    if (IN(5)) {
        pg8::Gemm g{(const pg8::bf16_t*)(P.ws + WS_HEADS), (const pg8::bf16_t*)(P.ws + WS_WOUT), MP, D, D};
        pg8::StaticOrder S; S.init(MP, D, gridDim.x, blockIdx.x);
        pg8::EpiF32 E{(float*)(P.ws + WS_MIX), D};
        pg8::gemm_phase<pg8::EpiF32, pg8::StaticOrder, true, true>(lds, g, S, E);
    }
    SEAM(5);
    if (IN(6)) ln_rows(P, 0);
    SEAM(6);
    if (IN(7)) {
        pg8::Gemm g{(const pg8::bf16_t*)(P.ws + WS_X1B), (const pg8::bf16_t*)(P.ws + WS_WUP), MP, FF, D};
        pg8::StaticOrder S; S.init(MP, FF, gridDim.x, blockIdx.x);
        pg8::EpiRelu2 E{(pg8::bf16_t*)(P.ws + WS_H), FF};
        pg8::gemm_phase<pg8::EpiRelu2, pg8::StaticOrder, true, true>(lds, g, S, E);
    }
    SEAM(7);
    if (IN(8)) {
        pg8::Gemm g{(const pg8::bf16_t*)(P.ws + WS_H), (const pg8::bf16_t*)(P.ws + WS_WDN), MP, D, FF};
        pg8::StaticOrder S; S.init(MP, D, gridDim.x, blockIdx.x);
        pg8::EpiF32 E{(float*)(P.ws + WS_F), D};
        pg8::gemm_phase<pg8::EpiF32, pg8::StaticOrder, true, true>(lds, g, S, E);
    }
    SEAM(8);
    if (IN(9)) ln_rows(P, 1);
#undef IN
#undef SEAM
}

#ifndef N_LAUNCH_PER_PHASE
#define N_LAUNCH_PER_PHASE 1
#endif
extern "C" void kernel_launch(void* const* d_in, const int* in_sizes, int n_in, void* d_out, int out_size, void* d_ws, size_t ws_size, hipStream_t stream) {
    static int grid = 0;
    if (grid == 0) {
        if (n_in != 13 || out_size != (int)O_END || ws_size < WS_END) { fprintf(stderr, "kernel_launch: unexpected sizes n_in %d out %d ws %zu\n", n_in, out_size, ws_size); grid = -1; return; }
        int dev = 0, cus = 0, per_cu = 0;
        (void)hipGetDevice(&dev); (void)hipDeviceGetAttribute(&cus, hipDeviceAttributeMultiprocessorCount, dev);
        (void)hipFuncSetAttribute((const void*)fwd_kernel, hipFuncAttributeMaxDynamicSharedMemorySize, LDS_BYTES);
        (void)hipOccupancyMaxActiveBlocksPerMultiprocessor(&per_cu, (const void*)fwd_kernel, NTHR, LDS_BYTES);
        if (per_cu < 1) { fprintf(stderr, "kernel_launch: occupancy query says %d blocks per CU\n", per_cu); grid = -1; return; }
        grid = cus;
        (void)hipGetLastError();
    }
    if (grid < 0) return;
    Params p{};
    p.x_prompt = (const float*)d_in[0]; p.x_sample = (const float*)d_in[1]; p.cache = (const float*)d_in[2]; p.state = (const float*)d_in[3];
    p.w_in = (const float*)d_in[4]; p.rel_bias = (const float*)d_in[5]; p.w_out = (const float*)d_in[6]; p.ln1_g = (const float*)d_in[7]; p.ln1_b = (const float*)d_in[8];
    p.w_up = (const float*)d_in[9]; p.w_down = (const float*)d_in[10]; p.ln2_g = (const float*)d_in[11]; p.ln2_b = (const float*)d_in[12];
    p.out = (float*)d_out; p.ws = (unsigned char*)d_ws;
#if N_LAUNCH_PER_PHASE
    for (int k = 0; k < NPHASE; ++k) { p.ph_lo = k; p.ph_hi = k + 1;
        void* args[] = {&p};
        hipError_t e = hipLaunchCooperativeKernel((const void*)fwd_kernel, dim3(grid), dim3(NTHR), args, LDS_BYTES, stream);
        if (e != hipSuccess) { fprintf(stderr, "kernel_launch: launch %d failed: %s\n", k, hipGetErrorString(e)); break; } }
#else
    p.ph_lo = 0; p.ph_hi = NPHASE;
    void* args[] = {&p};
    hipError_t e = hipLaunchCooperativeKernel((const void*)fwd_kernel, dim3(grid), dim3(NTHR), args, LDS_BYTES, stream);
    if (e != hipSuccess) fprintf(stderr, "kernel_launch: cooperative launch failed: %s (grid %d)\n", hipGetErrorString(e), grid);
#endif
}
```
